# Optimizing an MI355X kernel written in HIP

```python
import math
import jax, jax.numpy as jnp
from jax import lax
import numpy as np

D_MODEL = 1024
BATCH = 8
SEQ = 2048
DEPTH = 2

MEM_LEN = 256
MLA_HEADS = 8
MLA_NOPE_DIM = 64
MLA_ROPE_DIM = 32
MLA_V_DIM = 64
Q_LORA_RANK = 384
KV_LORA_RANK = 256
ROPE_THETA = 10000.0
DIL_HEADS = 8
DIL_HEAD_DIM = 64
DIL_PATTERNS = ((128, 1), (512, 4), (2048, 16))
N_BUCKETS = 32
MAX_DISTANCE = 2048
X_HEADS = 4
X_HEAD_DIM = D_MODEL // X_HEADS
D_FF = 4 * D_MODEL

Q_BLOCK = 128
EPS = 1e-6
MLA_WIDTH = MLA_HEADS * MLA_V_DIM
DIL_WIDTH = DIL_HEADS * DIL_HEAD_DIM
MIX_WIDTH = MLA_WIDTH + DIL_WIDTH
MLA_QK_DIM = MLA_NOPE_DIM + MLA_ROPE_DIM
IN_WIDTH = Q_LORA_RANK + KV_LORA_RANK + MLA_ROPE_DIM + 3 * DIL_WIDTH

kernel_name = "hymba_mla_dilated_hybrid_block"


def rms_norm(x, g):
    xf = x.astype(jnp.float32)
    y = xf * lax.rsqrt(jnp.mean(xf * xf, axis=-1, keepdims=True) + EPS)
    return (y * g.astype(jnp.float32)).astype(x.dtype)


def rope(x, positions):
    half = x.shape[-1] // 2
    inv = ROPE_THETA ** (-jnp.arange(half, dtype=jnp.float32) / half)
    ang = positions.astype(jnp.float32)[..., None] * inv
    cos = jnp.cos(ang)[:, :, None, :]
    sin = jnp.sin(ang)[:, :, None, :]
    x1 = x[..., :half].astype(jnp.float32)
    x2 = x[..., half:].astype(jnp.float32)
    out = jnp.concatenate([x1 * cos - x2 * sin, x2 * cos + x1 * sin], axis=-1)
    return out.astype(x.dtype)


def t5_bucket(dist):
    max_exact = N_BUCKETS // 2
    d = jnp.maximum(dist, 0)
    df = jnp.maximum(d.astype(jnp.float32), 1.0)
    large = max_exact + (jnp.log(df / max_exact) / math.log(MAX_DISTANCE / max_exact)
                         * (N_BUCKETS - max_exact)).astype(jnp.int32)
    large = jnp.minimum(large, N_BUCKETS - 1)
    return jnp.where(d < max_exact, d, large)


def causal_block_attention(q, k, v):
    B, S, H, Dqk = q.shape
    scale = Dqk ** -0.5
    nblk = S // Q_BLOCK
    qb = q.reshape(B, nblk, Q_BLOCK, H, Dqk).transpose(1, 0, 2, 3, 4)
    kpos = jnp.arange(S)

    def block(args):
        qi, bi = args
        s = jnp.einsum('bqhd,bkhd->bhqk', qi, k, preferred_element_type=jnp.float32) * scale
        qpos = bi * Q_BLOCK + jnp.arange(Q_BLOCK)
        s = jnp.where(kpos[None, :] <= qpos[:, None], s, -jnp.inf)
        p = jax.nn.softmax(s, axis=-1).astype(v.dtype)
        return jnp.einsum('bhqk,bkhd->bqhd', p, v)

    out = lax.map(block, (qb, jnp.arange(nblk)))
    return out.transpose(1, 0, 2, 3, 4).reshape(B, S, H, v.shape[-1])


def dilated_window_attention(q, k, v, rel_bias, window, dil):
    B, S, H, D = q.shape
    n = window // dil
    span = dil * n
    Sp = -(-S // span) * span
    L = Sp // dil
    nc = L // n
    scale = D ** -0.5

    def to_strided(t):
        t = jnp.pad(t, ((0, 0), (0, Sp - S), (0, 0), (0, 0)))
        t = t.reshape(B, L, dil, H, D)
        t = t.transpose(0, 2, 1, 3, 4)
        return t.reshape(B, dil, nc, n, H, D)

    qq, kc, vc = to_strided(q), to_strided(k), to_strided(v)

    def with_prev(t):
        prev = jnp.concatenate([jnp.zeros_like(t[:, :, :1]), t[:, :, :-1]], axis=2)
        return jnp.concatenate([prev, t], axis=3)

    kk, vv = with_prev(kc), with_prev(vc)

    i = jnp.arange(n)[:, None]
    m = jnp.arange(2 * n)[None, :]
    rel = n + i - m
    band = (rel >= 0) & (rel <= n)
    c = jnp.arange(nc)[:, None, None]
    mask = (band[None] & ((c > 0) | (m[None] >= n)))[:, None]
    bias = rel_bias.astype(jnp.float32)[t5_bucket(rel * dil)].transpose(2, 0, 1)

    s = jnp.einsum('brcqhd,brckhd->brchqk', qq, kk, preferred_element_type=jnp.float32) * scale + bias
    s = jnp.where(mask, s, -jnp.inf)
    s_max = jnp.max(s, axis=-1, keepdims=True)
    e = jnp.exp(s - s_max)
    den = jnp.sum(e, axis=-1)
    o = jnp.einsum('brchqk,brckhd->brcqhd', e, vv.astype(jnp.float32))
    den_q = den.transpose(0, 1, 2, 4, 3)
    o = o / den_q[..., None]
    lse = s_max[..., 0].transpose(0, 1, 2, 4, 3) + jnp.log(den_q)

    def from_strided(t):
        t = t.reshape((B, dil, L) + t.shape[4:])
        t = jnp.moveaxis(t, 1, 2)
        return t.reshape((B, Sp) + t.shape[3:])[:, :S]

    return from_strided(o), from_strided(lse)


def hybrid_mixer(h, positions, rel_bias, w_in, q_norm_g, w_uq, kv_norm_g, w_ukv, w_out):
    B, S, _ = h.shape
    z = h @ w_in
    o1 = Q_LORA_RANK
    o2 = o1 + KV_LORA_RANK
    o3 = o2 + MLA_ROPE_DIM
    o4 = o3 + DIL_WIDTH
    o5 = o4 + DIL_WIDTH
    c_q, c_kv, k_rope = z[..., :o1], z[..., o1:o2], z[..., o2:o3]
    q_d, k_d, v_d = z[..., o3:o4], z[..., o4:o5], z[..., o5:]

    q = (rms_norm(c_q, q_norm_g) @ w_uq).reshape(B, S, MLA_HEADS, MLA_QK_DIM)
    q = jnp.concatenate([q[..., :MLA_NOPE_DIM], rope(q[..., MLA_NOPE_DIM:], positions)], axis=-1)
    kv = (rms_norm(c_kv, kv_norm_g) @ w_ukv).reshape(B, S, MLA_HEADS, MLA_NOPE_DIM + MLA_V_DIM)
    k_nope, v_mla = kv[..., :MLA_NOPE_DIM], kv[..., MLA_NOPE_DIM:]
    k_pe = rope(k_rope[:, :, None, :], positions)
    k_pe = jnp.broadcast_to(k_pe, (B, S, MLA_HEADS, MLA_ROPE_DIM))
    k = jnp.concatenate([k_nope, k_pe], axis=-1)
    o_mla = causal_block_attention(q, k, v_mla).reshape(B, S, MLA_WIDTH)

    qd = q_d.reshape(B, S, DIL_HEADS, DIL_HEAD_DIM)
    kd = k_d.reshape(B, S, DIL_HEADS, DIL_HEAD_DIM)
    vd = v_d.reshape(B, S, DIL_HEADS, DIL_HEAD_DIM)
    outs, lses = [], []
    for window, dil in DIL_PATTERNS:
        o_p, lse_p = dilated_window_attention(qd, kd, vd, rel_bias, window, dil)
        outs.append(o_p)
        lses.append(lse_p)
    w = jax.nn.softmax(jnp.stack(lses, axis=0), axis=0)
    o_dil = jnp.sum(w[..., None] * jnp.stack(outs, axis=0), axis=0)
    o_dil = o_dil.astype(h.dtype).reshape(B, S, DIL_WIDTH)

    return jnp.concatenate([o_mla, o_dil], axis=-1) @ w_out


def memory_cross_attention(h, mem_n, w_xq, w_xk, w_xv, w_xo):
    B, S, _ = h.shape
    M = mem_n.shape[1]
    q = (h @ w_xq).reshape(B, S, X_HEADS, X_HEAD_DIM)
    k = (mem_n @ w_xk).reshape(B, M, X_HEADS, X_HEAD_DIM)
    v = (mem_n @ w_xv).reshape(B, M, X_HEADS, X_HEAD_DIM)
    s = jnp.einsum('bshd,bmhd->bhsm', q, k, preferred_element_type=jnp.float32) * (X_HEAD_DIM ** -0.5)
    p = jax.nn.softmax(s, axis=-1).astype(v.dtype)
    o = jnp.einsum('bhsm,bmhd->bshd', p, v).reshape(B, S, D_MODEL)
    return o @ w_xo


def setup_inputs(seed: int = 0) -> dict:
    key = jax.random.key(seed)
    ks = jax.random.split(key, 32)

    def w(k, shape, fan_in):
        return jax.random.normal(k, shape, jnp.float32) * fan_in ** -0.5

    def gain(k, dim):
        return 1.0 + 0.05 * jax.random.normal(k, (DEPTH, dim), jnp.float32)

    offset = jax.random.randint(ks[2], (BATCH, 1), 0, 1024, dtype=jnp.int32)
    positions = offset + jnp.arange(SEQ, dtype=jnp.int32)[None, :]
    return {
        "x": jax.random.normal(ks[0], (BATCH, SEQ, D_MODEL), jnp.float32),
        "mem": jax.random.normal(ks[1], (BATCH, MEM_LEN, D_MODEL), jnp.float32),
        "positions": positions,
        "rel_bias": 0.5 * jax.random.normal(ks[3], (N_BUCKETS, DIL_HEADS), jnp.float32),
        "w_in": w(ks[4], (DEPTH, D_MODEL, IN_WIDTH), D_MODEL),
        "q_norm_g": gain(ks[5], Q_LORA_RANK),
        "w_uq": w(ks[6], (DEPTH, Q_LORA_RANK, MLA_HEADS * MLA_QK_DIM), Q_LORA_RANK),
        "kv_norm_g": gain(ks[7], KV_LORA_RANK),
        "w_ukv": w(ks[8], (DEPTH, KV_LORA_RANK, MLA_HEADS * (MLA_NOPE_DIM + MLA_V_DIM)), KV_LORA_RANK),
        "w_mix_out": w(ks[9], (DEPTH, MIX_WIDTH, D_MODEL), MIX_WIDTH),
        "pre_mix_g": gain(ks[10], D_MODEL),
        "post_mix_g": gain(ks[11], D_MODEL),
        "w_xq": w(ks[12], (DEPTH, D_MODEL, D_MODEL), D_MODEL),
        "w_xk": w(ks[13], (DEPTH, D_MODEL, D_MODEL), D_MODEL),
        "w_xv": w(ks[14], (DEPTH, D_MODEL, D_MODEL), D_MODEL),
        "w_xo": w(ks[15], (DEPTH, D_MODEL, D_MODEL), D_MODEL),
        "mem_g": gain(ks[16], D_MODEL),
        "pre_xattn_g": gain(ks[17], D_MODEL),
        "post_xattn_g": gain(ks[18], D_MODEL),
        "w_up": w(ks[19], (DEPTH, D_MODEL, D_FF), D_MODEL),
        "w_down": w(ks[20], (DEPTH, D_FF, D_MODEL), D_FF),
        "pre_mlp_g": gain(ks[21], D_MODEL),
        "post_mlp_g": gain(ks[22], D_MODEL),
    }


def reference(x, mem, positions, rel_bias, w_in, q_norm_g, w_uq, kv_norm_g, w_ukv, w_mix_out,
              pre_mix_g, post_mix_g, w_xq, w_xk, w_xv, w_xo, mem_g, pre_xattn_g, post_xattn_g,
              w_up, w_down, pre_mlp_g, post_mlp_g):
    for l in range(DEPTH):
        a = hybrid_mixer(rms_norm(x, pre_mix_g[l]), positions, rel_bias, w_in[l], q_norm_g[l],
                         w_uq[l], kv_norm_g[l], w_ukv[l], w_mix_out[l])
        x = x + rms_norm(a, post_mix_g[l])
        c = memory_cross_attention(rms_norm(x, pre_xattn_g[l]), rms_norm(mem, mem_g[l]),
                                   w_xq[l], w_xk[l], w_xv[l], w_xo[l])
        x = x + rms_norm(c, post_xattn_g[l])
        hdn = jnp.square(jax.nn.relu(rms_norm(x, pre_mlp_g[l]) @ w_up[l]))
        x = x + rms_norm(hdn @ w_down[l], post_mlp_g[l])
    return x
```

```cpp
#include <hip/hip_runtime.h>
#include <cstdio>
#include <cstdint>

typedef unsigned short bf16_t;
typedef short bf16x8 __attribute__((ext_vector_type(8)));
typedef float f32x4 __attribute__((ext_vector_type(4)));

constexpr int NB = 8, SEQ = 2048, T = NB * SEQ, DM = 1024, DEPTH = 2, MEML = 256, DFF = 4096;
constexpr int QLR = 384, KVLR = 256, ROPE = 32, NH = 8;
constexpr int INW = 2208, ZW = 2304;
constexpr int Z_CQ = 0, Z_CKV = 384, Z_KPE = 640, Z_QD = 768, Z_KD = 1280, Z_VD = 1792;
constexpr int QW = 768, KVW = 1024;
constexpr float EPS = 1e-6f;
constexpr float LOG2E = 1.4426950408889634f;
constexpr float C2M = 0.10206207261596577f * LOG2E;
constexpr float C2D = 0.125f * LOG2E;
constexpr float C2X = 0.0625f * LOG2E;

constexpr size_t MiB = 1u << 20;
constexpr size_t WS_CTL = 0, WS_BIAS = 512 * 1024;
constexpr size_t WS_SSP = 3 * MiB;
constexpr size_t WS_W = 7 * MiB;
constexpr size_t W_IN = WS_W, W_UQ = W_IN + (size_t)ZW * DM * 2, W_UKV = W_UQ + (size_t)QW * QLR * 2, W_OUT = W_UKV + (size_t)KVW * KVLR * 2,
                 W_XQ = W_OUT + 2 * MiB, W_XKV = W_XQ + 2 * MiB, W_XO = W_XKV + 4 * MiB, W_UP = W_XO + 2 * MiB, W_DOWN = W_UP + 8 * MiB, W_END = W_DOWN + 8 * MiB;
static_assert(W_END <= 39 * MiB, "weights");
constexpr size_t WS_XN = 39 * MiB;
constexpr size_t WS_A = 71 * MiB;
constexpr size_t WS_Z = WS_A, WS_Q = WS_A + 72 * MiB, WS_KV = WS_Q + 24 * MiB, WS_H = WS_A;
constexpr size_t WS_OP = 199 * MiB;
constexpr size_t WS_P = WS_OP, WS_MEMN = WS_OP;
constexpr size_t WS_KVX = 247 * MiB;
constexpr size_t WS_O = WS_OP + 0;
constexpr size_t WS_WXQT = WS_OP + 40 * MiB;
constexpr size_t WS_QX = WS_A + 64 * MiB, WS_OX = WS_A + 96 * MiB;

__device__ __forceinline__ unsigned f2bf(float f) { unsigned u = __float_as_uint(f); return (u + 0x7fffu + ((u >> 16) & 1u)) >> 16; }
__device__ __forceinline__ float bf2f(bf16_t h) { return __uint_as_float((unsigned)h << 16); }
__device__ __forceinline__ float wave_sum(float v) {
#pragma unroll
    for (int o = 1; o < 64; o <<= 1) v += __shfl_xor(v, o);
    return v;
}
__device__ __forceinline__ float wave_max(float v) {
#pragma unroll
    for (int o = 1; o < 64; o <<= 1) v = fmaxf(v, __shfl_xor(v, o));
    return v;
}

enum { CM_ID = 0, CM_WIN = 1, CM_WUQ = 2, CM_WUKV = 3 };
template <int MODE> __device__ __forceinline__ int colmap(int n) {
    if (MODE == CM_WIN) {
        if (n < Z_KPE) return n;
        if (n < Z_KPE + ROPE) { const int j = n - Z_KPE; return 640 + (j >> 1) + 16 * (j & 1); }
        if (n < Z_QD) return -1;
        return 672 + (n - Z_QD);
    } else if (MODE == CM_WUQ) {
        if (n < 512) return (n >> 6) * 96 + (n & 63);
        const int m = n - 512, h = m >> 5, j = m & 31; return h * 96 + 64 + (j >> 1) + 16 * (j & 1);
    } else if (MODE == CM_WUKV) {
        if (n < 512) return (n >> 6) * 128 + (n & 63);
        const int m = n - 512; return (m >> 6) * 128 + 64 + (m & 63);
    }
    return n;
}
template <int MODE> __global__ void __launch_bounds__(256) k_cvt_w(const float* __restrict__ W, const float* __restrict__ gain, bf16_t* __restrict__ out, int K, int N) {
    __shared__ float tile[32][33];
    const int tx = threadIdx.x & 31, ty = threadIdx.x >> 5, n0 = blockIdx.x * 32, k0 = blockIdx.y * 32;
    const int col = colmap<MODE>(n0 + tx);
#pragma unroll
    for (int i = 0; i < 4; ++i) { const int k = k0 + ty + 8 * i; float v = 0.f; if (col >= 0) { v = W[(size_t)k * N + col]; if (gain) v *= gain[k]; } tile[ty + 8 * i][tx] = v; }
    __syncthreads();
#pragma unroll
    for (int i = 0; i < 4; ++i) { const int n = n0 + ty + 8 * i; out[(size_t)n * K + k0 + tx] = (bf16_t)f2bf(tile[tx][ty + 8 * i]); }
}
__global__ void __launch_bounds__(256) k_cast(const float* __restrict__ W, bf16_t* __restrict__ out, int n, int pad) {
    const int i = blockIdx.x * 256 + threadIdx.x; if (i < n) out[i] = (bf16_t)f2bf(W[i]);
}
__global__ void __launch_bounds__(256) k_rmsnorm(const float* __restrict__ x, const float* __restrict__ g, bf16_t* __restrict__ out, int rows, int pad) {
    const int row = blockIdx.x * 4 + (threadIdx.x >> 6), lane = threadIdx.x & 63; if (row >= rows) return;
    const f32x4* xr = (const f32x4*)(x + (size_t)row * DM) + lane; f32x4 v[4]; float s = 0.f;
#pragma unroll
    for (int j = 0; j < 4; ++j) { v[j] = xr[64 * j]; s += v[j].x * v[j].x + v[j].y * v[j].y + v[j].z * v[j].z + v[j].w * v[j].w; }
    const float rstd = rsqrtf(wave_sum(s) * (1.f / DM) + EPS);
#pragma unroll
    for (int j = 0; j < 4; ++j) { const f32x4 gg = ((const f32x4*)g)[lane + 64 * j]; bf16_t* o = out + (size_t)row * DM + 4 * (lane + 64 * j);
        o[0] = f2bf(v[j].x * rstd * gg.x); o[1] = f2bf(v[j].y * rstd * gg.y); o[2] = f2bf(v[j].z * rstd * gg.z); o[3] = f2bf(v[j].w * rstd * gg.w); }
}
__device__ __forceinline__ int t5_bucket(int dist) {
    if (dist < 16) return dist;
    int large = 16 + (int)(log((double)dist / 16.0) / log(128.0) * 16.0);
    return large > 31 ? 31 : large;
}
__global__ void k_bias(const float* __restrict__ rel_bias, float* __restrict__ tab) {
    const int e = blockIdx.x * 256 + threadIdx.x; if (e >= 3 * 8 * 129) return;
    const int p = e / (8 * 129), h = (e / 129) % 8, jj = e % 129, dil = p == 0 ? 1 : (p == 1 ? 4 : 16);
    tab[(p * 8 + h) * 132 + jj] = rel_bias[t5_bucket(jj * dil) * 8 + h] * LOG2E;
}

struct EpiInproj { bf16_t* Z; __device__ void operator()(int r, int c, float v) const { if (c >= Z_QD && c < Z_KD) v *= C2D; Z[(size_t)r * ZW + c] = (bf16_t)f2bf(v); } };
struct EpiScaled { bf16_t* O; const float* ssp; int ldc, s0, ns; float inv_n, mul; int pad;
    __device__ void operator()(int r, int c, float v) const { float s = 0.f; for (int i = 0; i < ns; ++i) s += ssp[(size_t)r * 24 + s0 + i]; O[(size_t)r * ldc + c] = (bf16_t)f2bf(v * rsqrtf(s * inv_n + EPS) * mul); } };
struct EpiPlain { bf16_t* O; int ldc, pad; __device__ void operator()(int r, int c, float v) const { O[(size_t)r * ldc + c] = (bf16_t)f2bf(v); } };
struct EpiRelu2 { bf16_t* O; int ldc, pad; __device__ void operator()(int r, int c, float v) const { v = fmaxf(v, 0.f); O[(size_t)r * ldc + c] = (bf16_t)f2bf(v * v); } };

template <class Epi> __global__ void __launch_bounds__(256) k_gemm(const bf16_t* __restrict__ A, const bf16_t* __restrict__ Bt, Epi E, int lda, int ldb, int N, int K) {
    const int wave = threadIdx.x >> 6, lane = threadIdx.x & 63, fr = lane & 15, fq = lane >> 4;
    const int R0 = blockIdx.x * 32, C0 = blockIdx.y * 1024 + wave * 256; if (C0 >= N) return;
    f32x4 acc[2][16];
#pragma unroll
    for (int m = 0; m < 2; ++m)
#pragma unroll
        for (int n = 0; n < 16; ++n) acc[m][n] = (f32x4){0.f, 0.f, 0.f, 0.f};
    const bf16_t* a0 = A + (size_t)(R0 + fr) * lda + 8 * fq; const bf16_t* b0 = Bt + (size_t)(C0 + fr) * ldb + 8 * fq;
    for (int k0 = 0; k0 < K; k0 += 32) {
        const bf16x8 a_0 = *(const bf16x8*)(a0 + k0), a_1 = *(const bf16x8*)(a0 + (size_t)16 * lda + k0);
#pragma unroll
        for (int n = 0; n < 16; ++n) { const bf16x8 b = *(const bf16x8*)(b0 + (size_t)(16 * n) * ldb + k0);
            acc[0][n] = __builtin_amdgcn_mfma_f32_16x16x32_bf16(a_0, b, acc[0][n], 0, 0, 0); acc[1][n] = __builtin_amdgcn_mfma_f32_16x16x32_bf16(a_1, b, acc[1][n], 0, 0, 0); }
    }
#pragma unroll
    for (int m = 0; m < 2; ++m)
#pragma unroll
        for (int n = 0; n < 16; ++n)
#pragma unroll
            for (int j = 0; j < 4; ++j) E(R0 + 16 * m + 4 * fq + j, C0 + 16 * n + fr, acc[m][n][j]);
}
__global__ void __launch_bounds__(256) k_gemm_norm(const bf16_t* __restrict__ A, const bf16_t* __restrict__ Bt, const float* base, float* out, const float* __restrict__ g1, const float* __restrict__ g2,
                                                  bf16_t* __restrict__ xn, int lda, int ldb, int K, int pad) {
    __shared__ float red[32][4];
    const int wave = threadIdx.x >> 6, lane = threadIdx.x & 63, fr = lane & 15, fq = lane >> 4;
    const int R0 = blockIdx.x * 32, C0 = wave * 256;
    f32x4 acc[2][16];
#pragma unroll
    for (int m = 0; m < 2; ++m)
#pragma unroll
        for (int n = 0; n < 16; ++n) acc[m][n] = (f32x4){0.f, 0.f, 0.f, 0.f};
    const bf16_t* a0 = A + (size_t)(R0 + fr) * lda + 8 * fq; const bf16_t* b0 = Bt + (size_t)(C0 + fr) * ldb + 8 * fq;
    for (int k0 = 0; k0 < K; k0 += 32) {
        const bf16x8 a_0 = *(const bf16x8*)(a0 + k0), a_1 = *(const bf16x8*)(a0 + (size_t)16 * lda + k0);
#pragma unroll
        for (int n = 0; n < 16; ++n) { const bf16x8 b = *(const bf16x8*)(b0 + (size_t)(16 * n) * ldb + k0);
            acc[0][n] = __builtin_amdgcn_mfma_f32_16x16x32_bf16(a_0, b, acc[0][n], 0, 0, 0); acc[1][n] = __builtin_amdgcn_mfma_f32_16x16x32_bf16(a_1, b, acc[1][n], 0, 0, 0); }
    }
    for (int pass = 0; pass < 2; ++pass) {
        float rs[2][4];
#pragma unroll
        for (int m = 0; m < 2; ++m)
#pragma unroll
            for (int j = 0; j < 4; ++j) { float s = 0.f;
#pragma unroll
                for (int n = 0; n < 16; ++n) s += acc[m][n][j] * acc[m][n][j];
                s += __shfl_xor(s, 1); s += __shfl_xor(s, 2); s += __shfl_xor(s, 4); s += __shfl_xor(s, 8);
                if (fr == 0) red[16 * m + 4 * fq + j][wave] = s; }
        __syncthreads();
#pragma unroll
        for (int m = 0; m < 2; ++m)
#pragma unroll
            for (int j = 0; j < 4; ++j) { const int rr = 16 * m + 4 * fq + j; rs[m][j] = rsqrtf((red[rr][0] + red[rr][1] + red[rr][2] + red[rr][3]) * (1.f / DM) + EPS); }
        __syncthreads();
        if (pass == 0) {
#pragma unroll
            for (int m = 0; m < 2; ++m)
#pragma unroll
                for (int n = 0; n < 16; ++n)
#pragma unroll
                    for (int j = 0; j < 4; ++j) { const int r = R0 + 16 * m + 4 * fq + j, c = C0 + 16 * n + fr; const float v = base[(size_t)r * DM + c] + acc[m][n][j] * rs[m][j] * g1[c];
                        out[(size_t)r * DM + c] = v; acc[m][n][j] = v; }
            if (!g2) break;
        } else {
#pragma unroll
            for (int m = 0; m < 2; ++m)
#pragma unroll
                for (int n = 0; n < 16; ++n)
#pragma unroll
                    for (int j = 0; j < 4; ++j) { const int r = R0 + 16 * m + 4 * fq + j, c = C0 + 16 * n + fr; xn[(size_t)r * DM + c] = (bf16_t)f2bf(acc[m][n][j] * rs[m][j] * g2[c]); }
        }
    }
}

__device__ __forceinline__ void rope_cs(int pos, int i, float& c, float& s) { const float inv = powf(10000.f, -(float)i / 16.f); const float ang = (float)pos * inv; c = cosf(ang); s = sinf(ang); }
__global__ void __launch_bounds__(256) k_lat_post(bf16_t* __restrict__ Z, float* __restrict__ ssp, const int* __restrict__ positions) {
    const int row = blockIdx.x * 4 + (threadIdx.x >> 6), lane = threadIdx.x & 63; bf16_t* z = Z + (size_t)row * ZW;
    float sq = 0.f, sk = 0.f;
    for (int c = lane; c < QLR; c += 64) { const float v = bf2f(z[Z_CQ + c]); sq += v * v; }
    for (int c = lane; c < KVLR; c += 64) { const float v = bf2f(z[Z_CKV + c]); sk += v * v; }
    sq = wave_sum(sq); sk = wave_sum(sk);
    if (lane < 24) ssp[(size_t)row * 24 + lane] = lane == 0 ? sq : (lane == 12 ? sk : 0.f);
    if (lane < 16) { float c, s; rope_cs(positions[row], lane, c, s); const float x1 = bf2f(z[Z_KPE + 2 * lane]), x2 = bf2f(z[Z_KPE + 2 * lane + 1]);
        z[Z_KPE + 2 * lane] = (bf16_t)f2bf(x1 * c - x2 * s); z[Z_KPE + 2 * lane + 1] = (bf16_t)f2bf(x2 * c + x1 * s); }
}
__global__ void __launch_bounds__(256) k_qrope(bf16_t* __restrict__ Q, const int* __restrict__ positions) {
    const int row = blockIdx.x * 4 + (threadIdx.x >> 6), lane = threadIdx.x & 63; bf16_t* q = Q + (size_t)row * QW + 512; const int pos = positions[row];
    for (int e = lane; e < 128; e += 64) { const int i = e & 15; float c, s; rope_cs(pos, i, c, s); const float x1 = bf2f(q[2 * e]), x2 = bf2f(q[2 * e + 1]);
        q[2 * e] = (bf16_t)f2bf(x1 * c - x2 * s); q[2 * e + 1] = (bf16_t)f2bf(x2 * c + x1 * s); }
}

__global__ void __launch_bounds__(256) k_mla_naive(const bf16_t* __restrict__ Q, const bf16_t* __restrict__ KV, const bf16_t* __restrict__ Z, bf16_t* __restrict__ O) {
    __shared__ float sc[4][SEQ]; __shared__ float qs[4][96];
    const int wave = threadIdx.x >> 6, lane = threadIdx.x & 63; const int id = blockIdx.x * 4 + wave, g = id >> 3, h = id & 7, b = g / SEQ, t = g % SEQ;
    for (int d = lane; d < 96; d += 64) qs[wave][d] = d < 64 ? bf2f(Q[(size_t)g * QW + 64 * h + d]) : bf2f(Q[(size_t)g * QW + 512 + 32 * h + (d - 64)]);
    __syncthreads();
    float mx = -1e30f;
    for (int j = lane; j <= t; j += 64) { const size_t gk = (size_t)b * SEQ + j; const bf16_t* kn = KV + gk * KVW + 64 * h; const bf16_t* kp = Z + gk * ZW + Z_KPE; float s = 0.f;
        for (int d = 0; d < 64; ++d) s += qs[wave][d] * bf2f(kn[d]);
        for (int d = 0; d < 32; ++d) s += qs[wave][64 + d] * bf2f(kp[d]);
        sc[wave][j] = s; mx = fmaxf(mx, s); }
    mx = wave_max(mx); float sum = 0.f;
    for (int j = lane; j <= t; j += 64) { const float p = exp2f(sc[wave][j] - mx); sc[wave][j] = p; sum += p; }
    sum = wave_sum(sum);
    __syncthreads();
    float o = 0.f;
    for (int j = 0; j <= t; ++j) o += sc[wave][j] * bf2f(KV[((size_t)b * SEQ + j) * KVW + 512 + 64 * h + lane]);
    O[(size_t)g * DM + 64 * h + lane] = (bf16_t)f2bf(o / sum);
}
__global__ void __launch_bounds__(256) k_dil_naive(const bf16_t* __restrict__ Z, const float* __restrict__ bias, bf16_t* __restrict__ O) {
    __shared__ float sc[4][392]; __shared__ float qs[4][64];
    const int wave = threadIdx.x >> 6, lane = threadIdx.x & 63; const int id = blockIdx.x * 4 + wave, g = id >> 3, h = id & 7, b = g / SEQ, t = g % SEQ;
    qs[wave][lane] = bf2f(Z[(size_t)g * ZW + Z_QD + 64 * h + lane]);
    __syncthreads();
    float mx = -1e30f;
    for (int e = lane; e < 387; e += 64) { const int p = e / 129, jj = e % 129, dil = p == 0 ? 1 : (p == 1 ? 4 : 16), pos = t - jj * dil; float s = -INFINITY;
        if (pos >= 0) { const bf16_t* kd = Z + ((size_t)b * SEQ + pos) * ZW + Z_KD + 64 * h; s = bias[(p * 8 + h) * 132 + jj];
            for (int d = 0; d < 64; ++d) s += qs[wave][d] * bf2f(kd[d]); }
        sc[wave][e] = s; mx = fmaxf(mx, s); }
    mx = wave_max(mx); float sum = 0.f;
    for (int e = lane; e < 387; e += 64) { const float p = exp2f(sc[wave][e] - mx); sc[wave][e] = p; sum += p; }
    sum = wave_sum(sum);
    __syncthreads();
    float o = 0.f;
    for (int e = 0; e < 387; ++e) { const int p = e / 129, jj = e % 129, dil = p == 0 ? 1 : (p == 1 ? 4 : 16), pos = t - jj * dil;
        if (pos >= 0) o += sc[wave][e] * bf2f(Z[((size_t)b * SEQ + pos) * ZW + Z_VD + 64 * h + lane]); }
    O[(size_t)g * DM + 512 + 64 * h + lane] = (bf16_t)f2bf(o / sum);
}
__global__ void __launch_bounds__(256) k_xattn_naive(const bf16_t* __restrict__ QX, const bf16_t* __restrict__ KVX, bf16_t* __restrict__ P) {
    __shared__ float qs[4][256];
    const int wave = threadIdx.x >> 6, lane = threadIdx.x & 63; const int id = blockIdx.x * 4 + wave, g = id >> 2, h = id & 3, b = g / SEQ;
    for (int d = lane; d < 256; d += 64) qs[wave][d] = bf2f(QX[(size_t)g * DM + 256 * h + d]);
    __syncthreads();
    float s[4]; float mx = -1e30f;
#pragma unroll
    for (int k = 0; k < 4; ++k) { const int m = lane + 64 * k; const bf16_t* kx = KVX + ((size_t)b * MEML + m) * 2048 + 256 * h; float a = 0.f;
        for (int d = 0; d < 256; ++d) a += qs[wave][d] * bf2f(kx[d]);
        s[k] = a * C2X; mx = fmaxf(mx, s[k]); }
    mx = wave_max(mx); float sum = 0.f;
#pragma unroll
    for (int k = 0; k < 4; ++k) { s[k] = exp2f(s[k] - mx); sum += s[k]; }
    sum = wave_sum(sum);
#pragma unroll
    for (int k = 0; k < 4; ++k) P[(size_t)g * DM + 256 * h + lane + 64 * k] = (bf16_t)f2bf(s[k] / sum);
}
__global__ void __launch_bounds__(256) k_xpv_naive(const bf16_t* __restrict__ P, const bf16_t* __restrict__ KVX, bf16_t* __restrict__ OX) {
    __shared__ float ps[4][256];
    const int wave = threadIdx.x >> 6, lane = threadIdx.x & 63; const int id = blockIdx.x * 4 + wave, g = id >> 2, h = id & 3, b = g / SEQ;
    for (int m = lane; m < 256; m += 64) ps[wave][m] = bf2f(P[(size_t)g * DM + 256 * h + m]);
    __syncthreads();
    float o[4] = {0.f, 0.f, 0.f, 0.f};
    for (int m = 0; m < 256; ++m) { const bf16_t* vx = KVX + ((size_t)b * MEML + m) * 2048 + 1024 + 256 * h; const float p = ps[wave][m];
#pragma unroll
        for (int k = 0; k < 4; ++k) o[k] += p * bf2f(vx[lane + 64 * k]); }
#pragma unroll
    for (int k = 0; k < 4; ++k) OX[(size_t)g * DM + 256 * h + lane + 64 * k] = (bf16_t)f2bf(o[k]);
}

template <int MODE> static void cvt(const float* W, int K, int N, int NP, const float* gain, bf16_t* out, hipStream_t s) { k_cvt_w<MODE><<<dim3(NP / 32, K / 32), 256, 0, s>>>(W, gain, out, K, N); }
template <class Epi> static void gemm(const bf16_t* A, int lda, const bf16_t* Bt, int ldb, int M, int N, int K, Epi E, hipStream_t s) { k_gemm<Epi><<<dim3(M / 32, (N + 1023) / 1024), 256, 0, s>>>(A, Bt, E, lda, ldb, N, K); }

extern "C" void kernel_launch(void* const* d_in, const int* in_sizes, int n_in, void* d_out, int out_size, void* d_ws, size_t ws_size, hipStream_t stream) {
    if (n_in != 23 || out_size != T * DM || ws_size < 256 * MiB) { fprintf(stderr, "kernel_launch: unexpected shapes n_in %d out %d ws %zu\n", n_in, out_size, ws_size); return; }
    const float* x = (const float*)d_in[0]; const float* mem = (const float*)d_in[1]; const int* positions = (const int*)d_in[2]; const float* rel_bias = (const float*)d_in[3];
    const float* w_in = (const float*)d_in[4]; const float* q_norm_g = (const float*)d_in[5]; const float* w_uq = (const float*)d_in[6]; const float* kv_norm_g = (const float*)d_in[7];
    const float* w_ukv = (const float*)d_in[8]; const float* w_mix_out = (const float*)d_in[9]; const float* pre_mix_g = (const float*)d_in[10]; const float* post_mix_g = (const float*)d_in[11];
    const float* w_xq = (const float*)d_in[12]; const float* w_xk = (const float*)d_in[13]; const float* w_xv = (const float*)d_in[14]; const float* w_xo = (const float*)d_in[15];
    const float* mem_g = (const float*)d_in[16]; const float* pre_xattn_g = (const float*)d_in[17]; const float* post_xattn_g = (const float*)d_in[18];
    const float* w_up = (const float*)d_in[19]; const float* w_down = (const float*)d_in[20]; const float* pre_mlp_g = (const float*)d_in[21]; const float* post_mlp_g = (const float*)d_in[22];
    unsigned char* ws = (unsigned char*)d_ws; float* out = (float*)d_out;
    bf16_t* Win_t = (bf16_t*)(ws + W_IN); bf16_t* Wuq_t = (bf16_t*)(ws + W_UQ); bf16_t* Wukv_t = (bf16_t*)(ws + W_UKV); bf16_t* Wout_t = (bf16_t*)(ws + W_OUT);
    bf16_t* Wxkv_t = (bf16_t*)(ws + W_XKV); bf16_t* Wxo_t = (bf16_t*)(ws + W_XO); bf16_t* Wup_t = (bf16_t*)(ws + W_UP); bf16_t* Wdown_t = (bf16_t*)(ws + W_DOWN);
    bf16_t* Wxq_t = (bf16_t*)(ws + WS_WXQT);
    bf16_t* XN = (bf16_t*)(ws + WS_XN); bf16_t* Z = (bf16_t*)(ws + WS_Z); bf16_t* Q = (bf16_t*)(ws + WS_Q); bf16_t* KV = (bf16_t*)(ws + WS_KV); bf16_t* H = (bf16_t*)(ws + WS_H);
    bf16_t* O = (bf16_t*)(ws + WS_O); bf16_t* P = (bf16_t*)(ws + WS_P); bf16_t* MEMN = (bf16_t*)(ws + WS_MEMN); bf16_t* KVX = (bf16_t*)(ws + WS_KVX);
    bf16_t* QX = (bf16_t*)(ws + WS_QX); bf16_t* OX = (bf16_t*)(ws + WS_OX);
    float* SSP = (float*)(ws + WS_SSP); float* BIAS = (float*)(ws + WS_BIAS);
    k_bias<<<(3 * 8 * 129 + 255) / 256, 256, 0, stream>>>(rel_bias, BIAS);
    for (int l = 0; l < DEPTH; ++l) {
        cvt<CM_WIN>(w_in + (size_t)l * DM * INW, DM, INW, ZW, nullptr, Win_t, stream);
        cvt<CM_WUQ>(w_uq + (size_t)l * QLR * QW, QLR, QW, QW, q_norm_g + l * QLR, Wuq_t, stream);
        cvt<CM_WUKV>(w_ukv + (size_t)l * KVLR * KVW, KVLR, KVW, KVW, kv_norm_g + l * KVLR, Wukv_t, stream);
        cvt<CM_ID>(w_mix_out + (size_t)l * DM * DM, DM, DM, DM, nullptr, Wout_t, stream);
        cvt<CM_ID>(w_xq + (size_t)l * DM * DM, DM, DM, DM, nullptr, Wxq_t, stream);
        cvt<CM_ID>(w_xk + (size_t)l * DM * DM, DM, DM, DM, nullptr, Wxkv_t, stream);
        cvt<CM_ID>(w_xv + (size_t)l * DM * DM, DM, DM, DM, nullptr, Wxkv_t + (size_t)DM * DM, stream);
        cvt<CM_ID>(w_xo + (size_t)l * DM * DM, DM, DM, DM, nullptr, Wxo_t, stream);
        cvt<CM_ID>(w_up + (size_t)l * DM * DFF, DM, DFF, DFF, nullptr, Wup_t, stream);
        cvt<CM_ID>(w_down + (size_t)l * DFF * DM, DFF, DM, DM, nullptr, Wdown_t, stream);
        if (l == 0) k_rmsnorm<<<T / 4, 256, 0, stream>>>(x, pre_mix_g, XN, T, 0);
        gemm(XN, DM, Win_t, DM, T, ZW, DM, EpiInproj{Z}, stream);
        k_lat_post<<<T / 4, 256, 0, stream>>>(Z, SSP, positions);
        gemm(Z + Z_CQ, ZW, Wuq_t, QLR, T, QW, QLR, EpiScaled{Q, SSP, QW, 0, 12, 1.f / QLR, C2M, 0}, stream);
        k_qrope<<<T / 4, 256, 0, stream>>>(Q, positions);
        gemm(Z + Z_CKV, ZW, Wukv_t, KVLR, T, KVW, KVLR, EpiScaled{KV, SSP, KVW, 12, 8, 1.f / KVLR, 1.f, 0}, stream);
        k_mla_naive<<<T * 8 / 4, 256, 0, stream>>>(Q, KV, Z, O);
        k_dil_naive<<<T * 8 / 4, 256, 0, stream>>>(Z, BIAS, O);
        k_gemm_norm<<<T / 32, 256, 0, stream>>>(O, Wout_t, l == 0 ? x : out, out, post_mix_g + l * DM, pre_xattn_g + l * DM, XN, DM, DM, DM, 0);
        k_rmsnorm<<<NB * MEML / 4, 256, 0, stream>>>(mem, mem_g + l * DM, MEMN, NB * MEML, 0);
        gemm(MEMN, DM, Wxkv_t, DM, NB * MEML, 2048, DM, EpiPlain{KVX, 2048, 0}, stream);
        gemm(XN, DM, Wxq_t, DM, T, DM, DM, EpiPlain{QX, DM, 0}, stream);
        k_xattn_naive<<<T * 4 / 4, 256, 0, stream>>>(QX, KVX, P);
        k_xpv_naive<<<T * 4 / 4, 256, 0, stream>>>(P, KVX, OX);
        k_gemm_norm<<<T / 32, 256, 0, stream>>>(OX, Wxo_t, out, out, post_xattn_g + l * DM, pre_mlp_g + l * DM, XN, DM, DM, DM, 0);
        gemm(XN, DM, Wup_t, DM, T, DFF, DM, EpiRelu2{H, DFF, 0}, stream);
        k_gemm_norm<<<T / 32, 256, 0, stream>>>(H, Wdown_t, out, out, post_mlp_g + l * DM, l + 1 < DEPTH ? pre_mix_g + (l + 1) * DM : nullptr, XN, DFF, DFF, DFF, 0);
    }
}
```
